# Optimizing an MI355X kernel written in HIP

```python
import jax, jax.numpy as jnp
from jax import lax
import numpy as np

D_MODEL = 1024
BATCH = 16
SEQ = 2048
DEPTH = 1

MIX_WIDTH = D_MODEL
HEAD_DIM = 64
A_WIDTH = MIX_WIDTH // 2
B_WIDTH = MIX_WIDTH - A_WIDTH
A_GROUPS = A_WIDTH // HEAD_DIM
A_GROUP_DIM = A_WIDTH // A_GROUPS
B_HEADS = B_WIDTH // HEAD_DIM
CHUNK = 128
Q_BLOCK = 128
D_FF = ((8 * D_MODEL // 3 + 255) // 256) * 256
COL_A_U = 0
COL_A_V = COL_A_U + A_WIDTH
COL_B_Q = COL_A_V + A_WIDTH
COL_B_K = COL_B_Q + B_WIDTH
COL_B_V = COL_B_K + B_WIDTH
COL_B_F = COL_B_V + B_WIDTH
IN_COLS = COL_B_F + B_HEADS
RMS_EPS = 1e-6
LN_EPS = 1e-5

kernel_name = "hymba_gmlp_fox_hybrid_block"


def _rmsnorm(x, g):
    x32 = x.astype(jnp.float32)
    y = x32 * lax.rsqrt(jnp.mean(x32 * x32, axis=-1, keepdims=True) + RMS_EPS)
    return (y * g.astype(jnp.float32)).astype(x.dtype)


def _layernorm(x, g, b):
    x32 = x.astype(jnp.float32)
    mu = jnp.mean(x32, axis=-1, keepdims=True)
    var = jnp.mean(jnp.square(x32 - mu), axis=-1, keepdims=True)
    y = (x32 - mu) * lax.rsqrt(var + LN_EPS)
    return (y * g.astype(jnp.float32) + b.astype(jnp.float32)).astype(x.dtype)


def _spatial_gating(u, v, ln_g, ln_b, w_s, b_s):
    B, S, _ = v.shape
    nc = S // CHUNK
    v = _layernorm(v, ln_g, ln_b)
    v = v.reshape(B, nc, CHUNK, A_GROUPS, A_GROUP_DIM)
    tril = jnp.tril(jnp.ones((CHUNK, CHUNK), dtype=w_s.dtype))
    w_masked = w_s * tril[None]
    mixed = jnp.einsum('gts,bcsgd->bctgd', w_masked, v) + b_s.T[None, None, :, :, None]
    out = u.reshape(B, nc, CHUNK, A_GROUPS, A_GROUP_DIM) * mixed
    return out.reshape(B, S, A_WIDTH)


def _forgetting_attention(q, k, v, f_logit, b_f):
    B, S, _ = q.shape
    def heads(t):
        return t.reshape(B, S, B_HEADS, HEAD_DIM).transpose(0, 2, 1, 3)
    q, k, v = heads(q), heads(k), heads(v)
    log_f = jax.nn.log_sigmoid(f_logit.astype(jnp.float32) + b_f.astype(jnp.float32))
    c = jnp.cumsum(log_f, axis=1).transpose(0, 2, 1)
    scale = HEAD_DIM ** -0.5
    pos = jnp.arange(S)
    outs = []
    for i in range(S // Q_BLOCK):
        q0, q1 = i * Q_BLOCK, (i + 1) * Q_BLOCK
        q_blk = q[:, :, q0:q1]
        k_blk = k[:, :, :q1]
        v_blk = v[:, :, :q1]
        logits = jnp.einsum('bhqd,bhkd->bhqk', q_blk, k_blk).astype(jnp.float32) * scale
        logits = logits + c[:, :, q0:q1, None] - c[:, :, None, :q1]
        mask = pos[q0:q1, None] >= pos[None, :q1]
        logits = jnp.where(mask[None, None], logits, -jnp.inf)
        p = jax.nn.softmax(logits, axis=-1).astype(v.dtype)
        outs.append(jnp.einsum('bhqk,bhkd->bhqd', p, v_blk))
    o = jnp.concatenate(outs, axis=2)
    return o.transpose(0, 2, 1, 3).reshape(B, S, B_WIDTH)


def setup_inputs(seed: int = 0) -> dict:
    key = jax.random.key(seed)
    ks = jax.random.split(key, 20)
    f32 = jnp.float32
    L = DEPTH
    def nrm(k, shape, scale):
        return jax.random.normal(k, shape, f32) * scale
    return {
        "x": jax.random.normal(ks[0], (BATCH, SEQ, D_MODEL), f32),
        "pre_mix_gain": 1.0 + nrm(ks[1], (L, D_MODEL), 0.02),
        "w_in": nrm(ks[2], (L, D_MODEL, IN_COLS), D_MODEL ** -0.5),
        "ln_v_gain": 1.0 + nrm(ks[3], (L, A_WIDTH), 0.02),
        "ln_v_bias": nrm(ks[4], (L, A_WIDTH), 0.02),
        "w_spatial": nrm(ks[5], (L, A_GROUPS, CHUNK, CHUNK), 0.5 * CHUNK ** -0.5),
        "b_spatial": 1.0 + nrm(ks[6], (L, A_GROUPS, CHUNK), 0.1),
        "b_forget": 2.0 + nrm(ks[7], (L, B_HEADS), 0.5),
        "out_norm_a_gain": 1.0 + nrm(ks[8], (L, A_WIDTH), 0.02),
        "out_norm_b_gain": 1.0 + nrm(ks[9], (L, B_WIDTH), 0.02),
        "w_out": nrm(ks[10], (L, MIX_WIDTH, D_MODEL), MIX_WIDTH ** -0.5),
        "post_mix_gain": 1.0 + nrm(ks[11], (L, D_MODEL), 0.02),
        "pre_ffn_gain": 1.0 + nrm(ks[12], (L, D_MODEL), 0.02),
        "w_ffn_in": nrm(ks[13], (L, D_MODEL, 2 * D_FF), D_MODEL ** -0.5),
        "w_ffn_out": nrm(ks[14], (L, D_FF, D_MODEL), D_FF ** -0.5),
        "post_ffn_gain": 1.0 + nrm(ks[15], (L, D_MODEL), 0.02),
    }


def reference(x, pre_mix_gain, w_in, ln_v_gain, ln_v_bias, w_spatial, b_spatial,
              b_forget, out_norm_a_gain, out_norm_b_gain, w_out, post_mix_gain,
              pre_ffn_gain, w_ffn_in, w_ffn_out, post_ffn_gain):
    h = x
    for l in range(DEPTH):
        n = _rmsnorm(h, pre_mix_gain[l])
        proj = jnp.einsum('bsd,dc->bsc', n, w_in[l])
        a_u = jax.nn.gelu(proj[..., COL_A_U:COL_A_V], approximate=False)
        a_v = jax.nn.gelu(proj[..., COL_A_V:COL_B_Q], approximate=False)
        a_out = _spatial_gating(a_u, a_v, ln_v_gain[l], ln_v_bias[l],
                                w_spatial[l], b_spatial[l])
        b_out = _forgetting_attention(proj[..., COL_B_Q:COL_B_K],
                                      proj[..., COL_B_K:COL_B_V],
                                      proj[..., COL_B_V:COL_B_F],
                                      proj[..., COL_B_F:IN_COLS],
                                      b_forget[l])
        merged = jnp.concatenate([_rmsnorm(a_out, out_norm_a_gain[l]),
                                  _rmsnorm(b_out, out_norm_b_gain[l])], axis=-1)
        mix = jnp.einsum('bsc,cd->bsd', merged, w_out[l])
        h = h + _rmsnorm(mix, post_mix_gain[l])
        n2 = _rmsnorm(h, pre_ffn_gain[l])
        gu = jnp.einsum('bsd,df->bsf', n2, w_ffn_in[l])
        ff = jax.nn.silu(gu[..., :D_FF]) * gu[..., D_FF:]
        ff = jnp.einsum('bsf,fd->bsd', ff, w_ffn_out[l])
        h = h + _rmsnorm(ff, post_ffn_gain[l])
    return h
```

```cpp
#include <hip/hip_runtime.h>
#include <cstdio>
#include <cstdint>

constexpr int NB = 16, SEQ = 2048, DM = 1024, NH = 8, HD = 64, AW = 512, FF = 2816;
constexpr int M = NB * SEQ;
constexpr int NPROJ = 2560, INCOLS = 2568;
constexpr int CHUNK = 128, NCHUNK = SEQ / CHUNK;
constexpr float RMS_EPS = 1e-6f, LN_EPS = 1e-5f;
constexpr float LOG2E = 1.4426950408889634f;
constexpr float C2 = 0.125f * LOG2E;

constexpr size_t MiB = 1u << 20;
constexpr size_t WS_CTL = 0, CTL_ZERO_BYTES = 1 * MiB;
constexpr size_t WS_WIN = 2 * MiB;
constexpr size_t WS_WO = 7 * MiB;
constexpr size_t WS_W1 = 9 * MiB;
constexpr size_t WS_W2 = 20 * MiB;
constexpr size_t WS_WSP = 26 * MiB;
constexpr size_t WS_LF = 27 * MiB;
constexpr size_t WS_CUM = 28 * MiB;
constexpr size_t WS_SSQ = 29 * MiB;
constexpr size_t WS_XCH = 31 * MiB;
constexpr size_t WS_XN = 36 * MiB;
constexpr size_t WS_U = 100 * MiB, WS_VG = 132 * MiB, WS_Q = 164 * MiB, WS_K = 196 * MiB, WS_V = 228 * MiB;
constexpr size_t WS_MG = 260 * MiB;
constexpr size_t WS_HB = 324 * MiB;
constexpr size_t WS_MIXF = 100 * MiB;
constexpr size_t WS_END = 500 * MiB;

typedef unsigned short bf16;
typedef unsigned v4u __attribute__((ext_vector_type(4)));
typedef unsigned v2u __attribute__((ext_vector_type(2)));
typedef float f32x4 __attribute__((ext_vector_type(4)));
typedef float f32x16 __attribute__((ext_vector_type(16)));
typedef short bf16x8 __attribute__((ext_vector_type(8)));
#define GAS __attribute__((address_space(1)))
#define LAS __attribute__((address_space(3)))

__device__ __forceinline__ unsigned f2bf(float f) { unsigned u = __builtin_bit_cast(unsigned, f); return (u + 0x7fffu + ((u >> 16) & 1u)) >> 16; }
__device__ __forceinline__ unsigned pk2(float lo, float hi) { return f2bf(lo) | (f2bf(hi) << 16); }
__device__ __forceinline__ float bf2f(unsigned short v) { return __builtin_bit_cast(float, (unsigned)v << 16); }
__device__ __forceinline__ float bflo(unsigned w) { return __builtin_bit_cast(float, w << 16); }
__device__ __forceinline__ float bfhi(unsigned w) { return __builtin_bit_cast(float, w & 0xffff0000u); }
__device__ __forceinline__ float wave_sum(float v) {
#pragma unroll
    for (int o = 1; o < 64; o <<= 1) v += __shfl_xor(v, o);
    return v;
}
__device__ __forceinline__ float wave_max(float v) {
#pragma unroll
    for (int o = 1; o < 64; o <<= 1) v = fmaxf(v, __shfl_xor(v, o));
    return v;
}

struct Ptrs {
    const float* in[16];
    float* out;
    unsigned char* ws;
};
enum { I_X = 0, I_G1, I_WIN, I_LNG, I_LNB, I_WSP, I_BSP, I_BF, I_GA, I_GB, I_WOUT, I_GPM, I_GPF, I_W1, I_W2, I_GPO };

__device__ __forceinline__ void p0_transpose_item(const float* W, int ldw, int K, const float* gain, bf16* WT, int k0, int n0, int drow, LAS float* scr, int lane) {
#pragma unroll 8
    for (int i = 0; i < 32; ++i) { const int kk = 2 * i + (lane >> 5); float w = W[(size_t)(k0 + kk) * ldw + n0 + (lane & 31)]; if (gain) w *= gain[k0 + kk]; scr[kk * 33 + (lane & 31)] = w; }
    asm volatile("s_waitcnt lgkmcnt(0)" ::: "memory");
    const int c = lane & 7;
#pragma unroll
    for (int j = 0; j < 4; ++j) { const int n = (lane >> 3) + 8 * j; const LAS float* s = scr + (8 * c) * 33 + n;
        v4u o; o.x = pk2(s[0 * 33], s[1 * 33]); o.y = pk2(s[2 * 33], s[3 * 33]); o.z = pk2(s[4 * 33], s[5 * 33]); o.w = pk2(s[6 * 33], s[7 * 33]);
        *(GAS v4u*)(WT + (size_t)(drow + n) * K + k0 + 8 * c) = o; }
    asm volatile("s_waitcnt lgkmcnt(0)" ::: "memory");
}
__device__ __forceinline__ float log_sigmoid_f(float x) { return fminf(x, 0.f) - log1pf(__expf(-fabsf(x))); }

__device__ __forceinline__ void p0_prologue(const Ptrs& P, LAS unsigned char* lds, int vcu, int G) {
    const int tid = threadIdx.x, lane = tid & 63, wave = __builtin_amdgcn_readfirstlane(tid >> 6);
    unsigned char* ws = P.ws;
    for (int k = tid; k < DM; k += 512) {
        const float g = P.in[I_G1][k]; const float* src = P.in[I_WIN] + (size_t)k * INCOLS + NPROJ;
        const f32x4 a = *(const f32x4*)src, b = *(const f32x4*)(src + 4);
        const float w8[8] = {a.x, a.y, a.z, a.w, b.x, b.y, b.z, b.w};
#pragma unroll
        for (int h = 0; h < 8; ++h) ((LAS float*)(lds + h * 16384 + 8704))[k] = w8[h] * g;
    }
    __syncthreads();
    LAS float* scr = (LAS float*)(lds + wave * 16384);
    const int gw = vcu * 8 + wave, NGW = G * 8;
    constexpr int I_A = (DM / 64) * (NPROJ / 32), I_B = (DM / 64) * (DM / 32), I_C = (DM / 64) * (2 * FF / 32), I_D = (FF / 64) * (DM / 32);
    constexpr int NITEMS = I_A + I_B + I_C + I_D;
    for (int it = gw; it < NITEMS; it += NGW) {
        int r = it;
        if (r < I_A) { const int nblk = NPROJ / 32, kb = r / nblk, nb = r % nblk; p0_transpose_item(P.in[I_WIN], INCOLS, DM, P.in[I_G1], (bf16*)(ws + WS_WIN), 64 * kb, 32 * nb, 32 * nb, scr, lane); continue; } r -= I_A;
        if (r < I_B) { const int nblk = DM / 32, kb = r / nblk, nb = r % nblk; const float* gain = (64 * kb < AW) ? P.in[I_GA] : (P.in[I_GB] - AW);
            p0_transpose_item(P.in[I_WOUT], DM, DM, gain, (bf16*)(ws + WS_WO), 64 * kb, 32 * nb, 32 * nb, scr, lane); continue; } r -= I_B;
        if (r < I_C) { const int nblk = 2 * FF / 32, kb = r / nblk, nb = r % nblk; const int n0 = 32 * nb; const int j = (n0 < FF) ? n0 : n0 - FF;
            const int drow = 256 * (j / 128) + (j % 128) + ((n0 < FF) ? 0 : 128);
            p0_transpose_item(P.in[I_W1], 2 * FF, DM, P.in[I_GPF], (bf16*)(ws + WS_W1), 64 * kb, n0, drow, scr, lane); continue; } r -= I_C;
        { const int nblk = DM / 32, kb = r / nblk, nb = r % nblk; p0_transpose_item(P.in[I_W2], DM, FF, nullptr, (bf16*)(ws + WS_W2), 64 * kb, 32 * nb, 32 * nb, scr, lane); }
    }
    for (int e = (vcu * 512 + tid) * 2; e < NH * CHUNK * CHUNK; e += G * 512 * 2) {
        const int s = e & 127, t = (e >> 7) & 127; const float* src = P.in[I_WSP] + e;
        const float a = (s <= t) ? src[0] : 0.f, b = (s + 1 <= t) ? src[1] : 0.f;
        *(GAS unsigned*)((bf16*)(ws + WS_WSP) + e) = pk2(a, b);
    }
    const float* bfg = P.in[I_BF];
    for (int m = gw; m < M; m += NGW) {
        const GAS f32x4* xr = (const GAS f32x4*)(P.in[I_X] + (size_t)m * DM) + lane;
        f32x4 v[4]; float s2 = 0.f;
#pragma unroll
        for (int j = 0; j < 4; ++j) { v[j] = xr[64 * j]; s2 += (v[j].x * v[j].x + v[j].y * v[j].y) + (v[j].z * v[j].z + v[j].w * v[j].w); }
        const float rstd = 1.f / sqrtf(wave_sum(s2) * (1.f / DM) + RMS_EPS);
        GAS unsigned long long* o8 = (GAS unsigned long long*)((bf16*)(ws + WS_XN) + (size_t)m * DM) + lane;
#pragma unroll
        for (int j = 0; j < 4; ++j) { v[j] = v[j] * rstd; o8[64 * j] = (unsigned long long)pk2(v[j].x, v[j].y) | ((unsigned long long)pk2(v[j].z, v[j].w) << 32); }
        float mine = 0.f;
#pragma unroll
        for (int h = 0; h < 8; ++h) {
            const LAS f32x4* wr = (const LAS f32x4*)(lds + h * 16384 + 8704) + lane; float a = 0.f;
#pragma unroll
            for (int j = 0; j < 4; ++j) { const f32x4 w = wr[64 * j]; a += (v[j].x * w.x + v[j].y * w.y) + (v[j].z * w.z + v[j].w * w.w); }
            a = wave_sum(a); if (lane == h) mine = a;
        }
        if (lane < 8) ((float*)(ws + WS_LF))[(size_t)m * 8 + lane] = LOG2E * log_sigmoid_f(mine + bfg[lane]);
    }
}

__device__ __forceinline__ void cumsum_batch(const Ptrs& P, int b) {
    const int tid = threadIdx.x, lane = tid & 63, h = tid >> 6;
    const float* lf = (const float*)(P.ws + WS_LF) + ((size_t)b * SEQ + 32 * lane) * 8 + h;
    float pre[32]; float run = 0.f;
#pragma unroll
    for (int i = 0; i < 32; ++i) { run += lf[i * 8]; pre[i] = run; }
    float inc = run;
#pragma unroll
    for (int o = 1; o < 64; o <<= 1) { const float t = __shfl_up(inc, o); if (lane >= o) inc += t; }
    const float excl = inc - run;
    float* dst = (float*)(P.ws + WS_CUM) + ((size_t)b * NH + h) * SEQ + 32 * lane;
#pragma unroll
    for (int i = 0; i < 32; i += 4) *(f32x4*)(dst + i) = (f32x4){pre[i] + excl, pre[i + 1] + excl, pre[i + 2] + excl, pre[i + 3] + excl};
}

__global__ void __launch_bounds__(512) k_prologue(Ptrs P) {
    extern __shared__ __attribute__((aligned(16))) unsigned char lds_n[];
    const int bx = blockIdx.x, G = gridDim.x;
    p0_prologue(P, (LAS unsigned char*)lds_n, bx, G);
}
__global__ void __launch_bounds__(512) k_cumsum(Ptrs P) { cumsum_batch(P, blockIdx.x); }

__device__ __forceinline__ float gelu_erf(float v) { return 0.5f * v * (1.f + erff(v * 0.70710678118654752f)); }
__device__ __forceinline__ int crow16(int r, int hi) { return (r & 3) + 8 * (r >> 2) + 4 * hi; }

template <int MODE> __global__ void __launch_bounds__(256) k_gemm_naive(Ptrs P) {
    const int lane = threadIdx.x & 63, r32 = lane & 31, hi = lane >> 5;
    const long gw = (long)blockIdx.x * 4 + (threadIdx.x >> 6);
    unsigned char* ws = P.ws;
    constexpr int NT = (MODE == 0) ? NPROJ / 32 : (MODE == 2) ? FF / 32 : DM / 32;
    constexpr int K = (MODE == 3) ? FF : DM;
    const int nt = (int)(gw % NT), mt = (int)(gw / NT); if (mt >= M / 32) return;
    const bf16* A = (const bf16*)(ws + ((MODE == 0 || MODE == 2) ? WS_XN : (MODE == 1) ? WS_MG : WS_HB));
    const bf16* Bt = (const bf16*)(ws + ((MODE == 0) ? WS_WIN : (MODE == 1) ? WS_WO : (MODE == 2) ? WS_W1 : WS_W2));
    const int m = mt * 32 + r32;
    int brow = nt * 32, brow2 = 0;
    if (MODE == 2) { const int j = nt * 32; brow = 256 * (j / 128) + (j % 128); brow2 = brow + 128; }
    const bf16* ap = A + (size_t)m * K + 8 * hi; const bf16* bp = Bt + (size_t)(brow + r32) * K + 8 * hi; const bf16* bp2 = Bt + (size_t)(brow2 + r32) * K + 8 * hi;
    f32x16 acc = {}, acc2 = {};
    for (int k0 = 0; k0 < K; k0 += 16) {
        const bf16x8 a = *(const bf16x8*)(ap + k0), b = *(const bf16x8*)(bp + k0);
        if (MODE == 1 && k0 >= AW) acc2 = __builtin_amdgcn_mfma_f32_32x32x16_bf16(b, a, acc2, 0, 0, 0);
        else acc = __builtin_amdgcn_mfma_f32_32x32x16_bf16(b, a, acc, 0, 0, 0);
        if (MODE == 2) { const bf16x8 b2 = *(const bf16x8*)(bp2 + k0); acc2 = __builtin_amdgcn_mfma_f32_32x32x16_bf16(b2, a, acc2, 0, 0, 0); }
    }
    if (MODE == 1) {
        const float* sq = (const float*)(ws + WS_SSQ) + (size_t)m * 16; float sa = 0.f, sb = 0.f;
        for (int i = 0; i < 8; ++i) { sa += sq[i]; sb += sq[8 + i]; }
        const float ra = 1.f / sqrtf(sa * (1.f / AW) + RMS_EPS), rb = 1.f / sqrtf(sb * (1.f / AW) + RMS_EPS);
        for (int r = 0; r < 16; ++r) acc[r] = acc[r] * ra + acc2[r] * rb;
    }
#pragma unroll
    for (int g = 0; g < 4; ++g) {
        const int n = nt * 32 + 8 * g + 4 * hi;
        float v[4];
#pragma unroll
        for (int i = 0; i < 4; ++i) v[i] = acc[4 * g + i];
        if (MODE == 0) {
            const int t5 = n / AW, cc = n % AW;
            bf16* dst = (bf16*)(ws + (t5 == 0 ? WS_U : t5 == 1 ? WS_VG : t5 == 2 ? WS_Q : t5 == 3 ? WS_K : WS_V));
#pragma unroll
            for (int i = 0; i < 4; ++i) { if (t5 < 2) v[i] = gelu_erf(v[i]); else if (t5 == 2) v[i] *= C2; }
            *(v2u*)(dst + (size_t)m * AW + cc) = (v2u){pk2(v[0], v[1]), pk2(v[2], v[3])};
        } else if (MODE == 2) {
#pragma unroll
            for (int i = 0; i < 4; ++i) { const float gt = v[i], up = acc2[4 * g + i]; v[i] = gt / (1.f + __expf(-gt)) * up; }
            *(v2u*)((bf16*)(ws + WS_HB) + (size_t)m * FF + n) = (v2u){pk2(v[0], v[1]), pk2(v[2], v[3])};
        } else {
            *(f32x4*)((float*)(ws + WS_MIXF) + (size_t)m * DM + n) = (f32x4){v[0], v[1], v[2], v[3]};
        }
    }
}

template <int MODE> __global__ void __launch_bounds__(256) k_rms_res(Ptrs P) {
    const int lane = threadIdx.x & 63; const int m = blockIdx.x * 4 + (threadIdx.x >> 6);
    const f32x4* mx = (const f32x4*)((const float*)(P.ws + WS_MIXF) + (size_t)m * DM) + lane;
    const f32x4* gp = (const f32x4*)(P.in[MODE == 0 ? I_GPM : I_GPO]) + lane;
    const f32x4* base = (const f32x4*)((MODE == 0 ? P.in[I_X] : P.out) + (size_t)m * DM) + lane;
    f32x4* o = (f32x4*)(P.out + (size_t)m * DM) + lane;
    f32x4 v[4]; float s2 = 0.f;
#pragma unroll
    for (int j = 0; j < 4; ++j) { v[j] = mx[64 * j]; s2 += (v[j].x * v[j].x + v[j].y * v[j].y) + (v[j].z * v[j].z + v[j].w * v[j].w); }
    const float r = 1.f / sqrtf(wave_sum(s2) * (1.f / DM) + RMS_EPS);
    float h2 = 0.f;
#pragma unroll
    for (int j = 0; j < 4; ++j) { v[j] = base[64 * j] + v[j] * r * gp[64 * j]; o[64 * j] = v[j]; h2 += (v[j].x * v[j].x + v[j].y * v[j].y) + (v[j].z * v[j].z + v[j].w * v[j].w); }
    if (MODE == 0) {
        const float r2 = 1.f / sqrtf(wave_sum(h2) * (1.f / DM) + RMS_EPS);
        GAS unsigned long long* o8 = (GAS unsigned long long*)((bf16*)(P.ws + WS_XN) + (size_t)m * DM) + lane;
#pragma unroll
        for (int j = 0; j < 4; ++j) o8[64 * j] = (unsigned long long)pk2(v[j].x * r2, v[j].y * r2) | ((unsigned long long)pk2(v[j].z * r2, v[j].w * r2) << 32);
    }
}

__global__ void __launch_bounds__(256) k_attn_naive(Ptrs P) {
    const int lane = threadIdx.x & 63; const int gw = blockIdx.x * 4 + (threadIdx.x >> 6);
    const int q = gw % SEQ, h = (gw / SEQ) % NH, b = gw / (SEQ * NH); const size_t m = (size_t)b * SEQ + q;
    const bf16* Qp = (const bf16*)(P.ws + WS_Q) + m * AW + h * HD;
    const bf16* Kp = (const bf16*)(P.ws + WS_K) + (size_t)b * SEQ * AW + h * HD;
    const bf16* Vp = (const bf16*)(P.ws + WS_V) + (size_t)b * SEQ * AW + h * HD;
    const float* cum = (const float*)(P.ws + WS_CUM) + ((size_t)b * NH + h) * SEQ;
    float qv[64];
#pragma unroll
    for (int i = 0; i < 8; ++i) { const v4u w = *(const v4u*)(Qp + 8 * i); qv[8 * i] = bflo(w.x); qv[8 * i + 1] = bfhi(w.x); qv[8 * i + 2] = bflo(w.y); qv[8 * i + 3] = bfhi(w.y); qv[8 * i + 4] = bflo(w.z); qv[8 * i + 5] = bfhi(w.z); qv[8 * i + 6] = bflo(w.w); qv[8 * i + 7] = bfhi(w.w); }
    const float cq = cum[q];
    float mrun = -INFINITY, l = 0.f, o = 0.f;
    for (int kt = 0; kt <= q / 64; ++kt) {
        const int j = kt * 64 + lane; const bool valid = j <= q;
        const bf16* kr = Kp + (size_t)j * AW; float dot = 0.f;
#pragma unroll
        for (int i = 0; i < 8; ++i) { const v4u w = *(const v4u*)(kr + 8 * i);
            dot += qv[8 * i] * bflo(w.x) + qv[8 * i + 1] * bfhi(w.x) + qv[8 * i + 2] * bflo(w.y) + qv[8 * i + 3] * bfhi(w.y) + qv[8 * i + 4] * bflo(w.z) + qv[8 * i + 5] * bfhi(w.z) + qv[8 * i + 6] * bflo(w.w) + qv[8 * i + 7] * bfhi(w.w); }
        const float s = valid ? dot + cq - cum[j] : -INFINITY;
        const float mnew = fmaxf(mrun, wave_max(s)); const float alpha = exp2f(mrun - mnew);
        const float p = valid ? exp2f(s - mnew) : 0.f;
        l = l * alpha + wave_sum(p); o *= alpha;
        for (int jj = 0; jj < 64; ++jj) { const float pj = __shfl(p, jj); o += pj * bf2f(Vp[(size_t)(kt * 64 + jj) * AW + lane]); }
        mrun = mnew;
    }
    o /= l;
    const unsigned short ob = (unsigned short)f2bf(o);
    ((bf16*)(P.ws + WS_MG))[m * DM + AW + h * HD + lane] = ob;
    const float of = bf2f(ob); const float ss = wave_sum(of * of);
    if (lane == 0) ((float*)(P.ws + WS_SSQ))[m * 16 + 8 + h] = ss;
}

__global__ void __launch_bounds__(512) k_sgu_naive(Ptrs P) {
    __shared__ float mu[CHUNK], rs[CHUNK];
    const int tid = threadIdx.x, lane = tid & 63, wave = tid >> 6;
    const size_t m0 = (size_t)blockIdx.x * CHUNK;
    const bf16* VG = (const bf16*)(P.ws + WS_VG) + m0 * AW; const bf16* U = (const bf16*)(P.ws + WS_U) + m0 * AW;
    for (int i = 0; i < 16; ++i) { const int row = wave * 16 + i; const v4u w = *(const v4u*)(VG + (size_t)row * AW + 8 * lane);
        const float x[8] = {bflo(w.x), bfhi(w.x), bflo(w.y), bfhi(w.y), bflo(w.z), bfhi(w.z), bflo(w.w), bfhi(w.w)};
        float s = 0.f; for (int k = 0; k < 8; ++k) s += x[k];
        const float mean = wave_sum(s) * (1.f / AW); float q = 0.f; for (int k = 0; k < 8; ++k) q += (x[k] - mean) * (x[k] - mean);
        const float var = wave_sum(q) * (1.f / AW);
        if (lane == 0) { mu[row] = mean; rs[row] = 1.f / sqrtf(var + LN_EPS); } }
    __syncthreads();
    const int ch = tid, g = wave;
    const float lg = P.in[I_LNG][ch], lb = P.in[I_LNB][ch];
    const bf16* W = (const bf16*)(P.ws + WS_WSP) + (size_t)g * CHUNK * CHUNK;
    float acc[CHUNK];
#pragma unroll
    for (int t = 0; t < CHUNK; ++t) acc[t] = P.in[I_BSP][g * CHUNK + t];
    for (int s = 0; s < CHUNK; ++s) {
        const float vn = (bf2f(VG[(size_t)s * AW + ch]) - mu[s]) * rs[s] * lg + lb;
#pragma unroll
        for (int t = 0; t < CHUNK; ++t) acc[t] += bf2f(W[t * CHUNK + s]) * vn;
    }
#pragma unroll
    for (int t = 0; t < CHUNK; ++t) {
        const float a = bf2f(U[(size_t)t * AW + ch]) * acc[t]; const unsigned short ab = (unsigned short)f2bf(a);
        ((bf16*)(P.ws + WS_MG))[(m0 + t) * DM + ch] = ab;
        const float af = bf2f(ab); const float ss = wave_sum(af * af);
        if (lane == 0) ((float*)(P.ws + WS_SSQ))[(m0 + t) * 16 + g] = ss;
    }
}

static void launch_naive(const Ptrs& P, hipStream_t stream) {
    static bool attr = false;
    if (!attr) { (void)hipFuncSetAttribute((const void*)k_prologue, hipFuncAttributeMaxDynamicSharedMemorySize, 131072); attr = true; }
    hipLaunchKernelGGL(k_prologue, dim3(256), dim3(512), 131072, stream, P);
    hipLaunchKernelGGL(k_cumsum, dim3(NB), dim3(512), 0, stream, P);
    hipLaunchKernelGGL(k_gemm_naive<0>, dim3((M / 32) * (NPROJ / 32) / 4), dim3(256), 0, stream, P);
    hipLaunchKernelGGL(k_attn_naive, dim3(NB * NH * SEQ / 4), dim3(256), 0, stream, P);
    hipLaunchKernelGGL(k_sgu_naive, dim3(NB * NCHUNK), dim3(512), 0, stream, P);
    hipLaunchKernelGGL(k_gemm_naive<1>, dim3((M / 32) * (DM / 32) / 4), dim3(256), 0, stream, P);
    hipLaunchKernelGGL(k_rms_res<0>, dim3(M / 4), dim3(256), 0, stream, P);
    hipLaunchKernelGGL(k_gemm_naive<2>, dim3((M / 32) * (FF / 32) / 4), dim3(256), 0, stream, P);
    hipLaunchKernelGGL(k_gemm_naive<3>, dim3((M / 32) * (DM / 32) / 4), dim3(256), 0, stream, P);
    hipLaunchKernelGGL(k_rms_res<1>, dim3(M / 4), dim3(256), 0, stream, P);
}

extern "C" void kernel_launch(void* const* d_in, const int* in_sizes, int n_in, void* d_out, int out_size, void* d_ws, size_t ws_size, hipStream_t stream) {
    if (n_in != 16 || in_sizes[0] != M * DM || out_size != M * DM || ws_size < WS_END) { fprintf(stderr, "kernel_launch: unexpected shapes (n_in %d, in0 %d, out %d, ws %zu)\n", n_in, n_in > 0 ? in_sizes[0] : -1, out_size, ws_size); return; }
    Ptrs P{};
    for (int i = 0; i < 16; ++i) P.in[i] = (const float*)d_in[i];
    P.out = (float*)d_out; P.ws = (unsigned char*)d_ws;
    launch_naive(P, stream);
}
```
